# Optimizing an MI355X kernel written in HIP

```python
import math
import jax, jax.numpy as jnp
from jax import lax
import numpy as np

D_MODEL = 1024
BATCH = 4
SEQ = 8192
DEPTH = 1

ATTN_HEADS = 8
ATTN_HEAD_DIM = 64
ATTN_WIDTH = ATTN_HEADS * ATTN_HEAD_DIM
GMLP_GROUPS = 8
GMLP_GROUP_DIM = 64
GMLP_WIDTH = GMLP_GROUPS * GMLP_GROUP_DIM
MIX_WIDTH = ATTN_WIDTH + GMLP_WIDTH
IN_COLS = 3 * ATTN_WIDTH + 2 * GMLP_WIDTH
Q_BLOCK = 128
GMLP_CHUNK = 128
PEER_HEADS = 8
PEER_N_KEYS = 128
PEER_N_EXPERTS = PEER_N_KEYS * PEER_N_KEYS
PEER_QUERY_DIM = 256
PEER_HALF = PEER_QUERY_DIM // 2
PEER_TOPK = 16
PEER_TOKEN_BLOCK = 128
PLE_DIM = 256
LN_EPS = 1e-5
DEEPNORM_ALPHA = (2.0 * DEPTH) ** 0.25
DEEPNORM_BETA = (8.0 * DEPTH) ** -0.25

kernel_name = "hybrid_sb_attn_gmlp_peer_deepnorm"


def layer_norm(x, g, b):
    xf = x.astype(jnp.float32)
    mu = jnp.mean(xf, axis=-1, keepdims=True)
    var = jnp.mean(jnp.square(xf - mu), axis=-1, keepdims=True)
    y = (xf - mu) * lax.rsqrt(var + LN_EPS)
    return (y * g.astype(jnp.float32) + b.astype(jnp.float32)).astype(x.dtype)


def rms_norm(x, g):
    xf = x.astype(jnp.float32)
    y = xf * lax.rsqrt(jnp.mean(jnp.square(xf), axis=-1, keepdims=True) + LN_EPS)
    return (y * g.astype(jnp.float32)).astype(x.dtype)


def stick_breaking_attention(q, k, v):
    B, S, H, dh = q.shape
    nb = S // Q_BLOCK
    qh = q.transpose(0, 2, 1, 3)
    kh = k.transpose(0, 2, 1, 3)
    vh = v.transpose(0, 2, 1, 3)
    q_blocks = qh.reshape(B, H, nb, Q_BLOCK, dh).transpose(2, 0, 1, 3, 4)
    starts = jnp.arange(nb, dtype=jnp.int32) * Q_BLOCK
    scale = 1.0 / math.sqrt(dh)
    s_idx = jnp.arange(S, dtype=jnp.int32)

    def block(args):
        qb, start = args
        z = jnp.einsum('bhtd,bhsd->bhts', qb, kh).astype(jnp.float32) * scale
        t_idx = start + jnp.arange(Q_BLOCK, dtype=jnp.int32)
        mask = s_idx[None, :] < t_idx[:, None]
        log_beta = jax.nn.log_sigmoid(z)
        log_1m_beta = jnp.where(mask, jax.nn.log_sigmoid(-z), 0.0)
        suffix = lax.cumsum(log_1m_beta, axis=3, reverse=True) - log_1m_beta
        a = jnp.where(mask, jnp.exp(log_beta + suffix), 0.0)
        return jnp.einsum('bhts,bhsd->bhtd', a.astype(vh.dtype), vh)

    out = lax.map(block, (q_blocks, starts))
    return out.transpose(1, 0, 3, 2, 4).reshape(B, S, H * dh)


def gmlp_spatial_gating(u, v, vn_g, vn_b, w_s, b_s):
    B, S, _ = v.shape
    nc = S // GMLP_CHUNK
    v = layer_norm(v, vn_g, vn_b)
    vc = v.reshape(B, nc, GMLP_CHUNK, GMLP_GROUPS, GMLP_GROUP_DIM)
    causal = jnp.tril(jnp.ones((GMLP_CHUNK, GMLP_CHUNK), dtype=w_s.dtype))
    mixed = jnp.einsum('gts,bcsgd->bctgd', w_s * causal[None], vc)
    mixed = mixed + b_s.T[None, None, :, :, None]
    return u * mixed.reshape(B, S, GMLP_WIDTH)


def peer(x, w_q, sub_keys, u_tab, v_tab):
    B, S, D = x.shape
    q = (x @ w_q).reshape(B, S, PEER_HEADS, 2, PEER_HALF)
    scores = jnp.einsum('bshpk,hpnk->bshpn', q, sub_keys).astype(jnp.float32)
    s1, i1 = lax.top_k(scores[:, :, :, 0, :], PEER_TOPK)
    s2, i2 = lax.top_k(scores[:, :, :, 1, :], PEER_TOPK)
    cand = (s1[..., :, None] + s2[..., None, :]).reshape(B, S, PEER_HEADS, PEER_TOPK * PEER_TOPK)
    top_s, top_c = lax.top_k(cand, PEER_TOPK)
    ia = top_c // PEER_TOPK
    ib = top_c % PEER_TOPK
    ids = (jnp.take_along_axis(i1, ia, axis=-1) * PEER_N_KEYS
           + jnp.take_along_axis(i2, ib, axis=-1))
    gates = jax.nn.softmax(top_s, axis=-1).astype(x.dtype)

    T = B * S
    nblk = T // PEER_TOKEN_BLOCK
    xt = x.reshape(nblk, PEER_TOKEN_BLOCK, D)
    idt = ids.reshape(nblk, PEER_TOKEN_BLOCK, PEER_HEADS, PEER_TOPK)
    gt = gates.reshape(nblk, PEER_TOKEN_BLOCK, PEER_HEADS, PEER_TOPK)

    def block(args):
        xb, idb, gb = args
        ue = jnp.take(u_tab, idb, axis=0)
        h = jnp.einsum('thkd,td->thk', ue, xb)
        act = gb * jax.nn.gelu(h, approximate=False)
        ve = jnp.take(v_tab, idb, axis=0)
        return jnp.einsum('thk,thkd->td', act, ve)

    out = lax.map(block, (xt, idt, gt))
    return out.reshape(B, S, D)


def setup_inputs(seed: int = 0) -> dict:
    key = jax.random.key(seed)
    ks = jax.random.split(key, 24)
    f32 = jnp.float32
    n = lambda k, shape, s: jax.random.normal(k, shape, f32) * s
    L = DEPTH
    return {
        "x": n(ks[0], (BATCH, SEQ, D_MODEL), 1.0),
        "p": n(ks[1], (DEPTH, BATCH, SEQ, PLE_DIM), 1.0),
        "w_in": n(ks[2], (L, D_MODEL, IN_COLS), D_MODEL ** -0.5),
        "attn_out_g": 1.0 + n(ks[3], (L, ATTN_WIDTH), 0.05),
        "gmlp_vn_g": 1.0 + n(ks[4], (L, GMLP_WIDTH), 0.05),
        "gmlp_vn_b": n(ks[5], (L, GMLP_WIDTH), 0.02),
        "gmlp_ws": n(ks[6], (L, GMLP_GROUPS, GMLP_CHUNK, GMLP_CHUNK), GMLP_CHUNK ** -0.5),
        "gmlp_bs": 1.0 + n(ks[7], (L, GMLP_GROUPS, GMLP_CHUNK), 0.1),
        "gmlp_out_g": 1.0 + n(ks[8], (L, GMLP_WIDTH), 0.05),
        "w_out": n(ks[9], (L, MIX_WIDTH, D_MODEL), MIX_WIDTH ** -0.5 * DEEPNORM_BETA),
        "ln1_g": 1.0 + n(ks[10], (L, D_MODEL), 0.05),
        "ln1_b": n(ks[11], (L, D_MODEL), 0.02),
        "peer_wq": n(ks[12], (L, D_MODEL, PEER_HEADS * PEER_QUERY_DIM), D_MODEL ** -0.5),
        "peer_subkeys": n(ks[13], (L, PEER_HEADS, 2, PEER_N_KEYS, PEER_HALF), PEER_HALF ** -0.5),
        "peer_u": n(ks[14], (L, PEER_N_EXPERTS, D_MODEL), D_MODEL ** -0.5),
        "peer_v": n(ks[15], (L, PEER_N_EXPERTS, D_MODEL), DEEPNORM_BETA),
        "ln2_g": 1.0 + n(ks[16], (L, D_MODEL), 0.05),
        "ln2_b": n(ks[17], (L, D_MODEL), 0.02),
        "ple_wproj": n(ks[18], (L, PLE_DIM, D_MODEL), PLE_DIM ** -0.5 * DEEPNORM_BETA),
        "ple_wgate": n(ks[19], (L, D_MODEL, D_MODEL), D_MODEL ** -0.5),
        "ple_bgate": n(ks[20], (L, D_MODEL), 0.02),
        "ln3_g": 1.0 + n(ks[21], (L, D_MODEL), 0.05),
        "ln3_b": n(ks[22], (L, D_MODEL), 0.02),
    }


def reference(x, p, w_in, attn_out_g, gmlp_vn_g, gmlp_vn_b, gmlp_ws, gmlp_bs, gmlp_out_g, w_out,
              ln1_g, ln1_b, peer_wq, peer_subkeys, peer_u, peer_v, ln2_g, ln2_b,
              ple_wproj, ple_wgate, ple_bgate, ln3_g, ln3_b):
    B, S, D = x.shape
    for i in range(DEPTH):
        h = x @ w_in[i]
        q, k, v, gu, gv = jnp.split(
            h, [ATTN_WIDTH, 2 * ATTN_WIDTH, 3 * ATTN_WIDTH, 3 * ATTN_WIDTH + GMLP_WIDTH], axis=-1)
        hs = (B, S, ATTN_HEADS, ATTN_HEAD_DIM)
        attn = stick_breaking_attention(q.reshape(hs), k.reshape(hs), v.reshape(hs))
        attn = rms_norm(attn, attn_out_g[i])
        gm = gmlp_spatial_gating(jax.nn.gelu(gu, approximate=False), jax.nn.gelu(gv, approximate=False),
                                 gmlp_vn_g[i], gmlp_vn_b[i], gmlp_ws[i], gmlp_bs[i])
        gm = rms_norm(gm, gmlp_out_g[i])
        mix = jnp.concatenate([attn, gm], axis=-1) @ w_out[i]
        x = layer_norm(DEEPNORM_ALPHA * x + mix, ln1_g[i], ln1_b[i])
        ffn = peer(x, peer_wq[i], peer_subkeys[i], peer_u[i], peer_v[i])
        x = layer_norm(DEEPNORM_ALPHA * x + ffn, ln2_g[i], ln2_b[i])
        gate = jax.nn.sigmoid(x @ ple_wgate[i] + ple_bgate[i])
        ple = gate * (p[i] @ ple_wproj[i])
        x = layer_norm(DEEPNORM_ALPHA * x + ple, ln3_g[i], ln3_b[i])
    return x
```

```cpp
#include <hip/hip_runtime.h>
#include <stdint.h>

typedef float f32x4 __attribute__((ext_vector_type(4)));

constexpr int BATCH = 4, SEQ = 8192, T = BATCH * SEQ, DM = 1024, INC = 2560;
constexpr int NH = 8, HD = 64, AW = 512, GW = 512, CH = 128;
constexpr int PH = 8, PNK = 128, PHALF = 128, PQD = 256, PTOPK = 16;
constexpr float LN_EPS = 1e-5f;
constexpr float ALPHA = 1.189207115002721f;

__global__ __launch_bounds__(256) void gemm_f32(const float* __restrict__ A, int lda, const float* __restrict__ B, int ldb, float* __restrict__ C, int ldc, int K) {
    __shared__ float sA[64][20];
    __shared__ float sB[16][68];
    const int tid = threadIdx.x, lane = tid & 63, w = tid >> 6;
    const int m0 = blockIdx.y * 64, n0 = blockIdx.x * 64;
    f32x4 acc[4];
#pragma unroll
    for (int i = 0; i < 4; ++i) acc[i] = (f32x4){0.f, 0.f, 0.f, 0.f};
    const int ar = tid >> 2, ac = (tid & 3) * 4;
    const int br = tid >> 4, bc = (tid & 15) * 4;
    for (int k0 = 0; k0 < K; k0 += 16) {
        const f32x4 av = *(const f32x4*)(A + (size_t)(m0 + ar) * lda + k0 + ac);
        const f32x4 bv = *(const f32x4*)(B + (size_t)(k0 + br) * ldb + n0 + bc);
        __syncthreads();
        sA[ar][ac + 0] = av[0]; sA[ar][ac + 1] = av[1]; sA[ar][ac + 2] = av[2]; sA[ar][ac + 3] = av[3];
        sB[br][bc + 0] = bv[0]; sB[br][bc + 1] = bv[1]; sB[br][bc + 2] = bv[2]; sB[br][bc + 3] = bv[3];
        __syncthreads();
#pragma unroll
        for (int ks = 0; ks < 4; ++ks) {
            const float a = sA[16 * w + (lane & 15)][4 * ks + (lane >> 4)];
#pragma unroll
            for (int nt = 0; nt < 4; ++nt) {
                const float b = sB[4 * ks + (lane >> 4)][16 * nt + (lane & 15)];
                acc[nt] = __builtin_amdgcn_mfma_f32_16x16x4f32(a, b, acc[nt], 0, 0, 0);
            }
        }
    }
#pragma unroll
    for (int nt = 0; nt < 4; ++nt)
#pragma unroll
        for (int j = 0; j < 4; ++j)
            C[(size_t)(m0 + 16 * w + (lane >> 4) * 4 + j) * ldc + n0 + 16 * nt + (lane & 15)] = acc[nt][j];
}

__device__ __forceinline__ float wave_sum(float v) {
#pragma unroll
    for (int o = 1; o < 64; o <<= 1) v += __shfl_xor(v, o);
    return v;
}
__device__ __forceinline__ float wave_max(float v) {
#pragma unroll
    for (int o = 1; o < 64; o <<= 1) v = fmaxf(v, __shfl_xor(v, o));
    return v;
}
__device__ __forceinline__ float gelu_exact(float x) { return 0.5f * x * (1.0f + erff(x * 0.70710678118654752f)); }

__global__ __launch_bounds__(64) void attn_naive(const float* __restrict__ H, float* __restrict__ CAT) {
    const int gid = blockIdx.x * 64 + threadIdx.x;
    const int t = gid % SEQ, bh = gid / SEQ, hh = bh % NH, b = bh / NH;
    const float* qp = H + (size_t)(b * SEQ + t) * INC + hh * HD;
    float q[HD], acc[HD];
#pragma unroll
    for (int d = 0; d < HD; ++d) { q[d] = qp[d] * 0.125f; acc[d] = 0.f; }
    float run = 0.f;
    for (int s = t - 1; s >= 0; --s) {
        const float* kp = H + (size_t)(b * SEQ + s) * INC + AW + hh * HD;
        float z = 0.f;
#pragma unroll
        for (int d = 0; d < HD; d += 4) { const f32x4 kv = *(const f32x4*)(kp + d); z += q[d] * kv[0] + q[d + 1] * kv[1] + q[d + 2] * kv[2] + q[d + 3] * kv[3]; }
        const float sp = fmaxf(z, 0.f) + log1pf(expf(-fabsf(z)));
        const float a = expf((z - sp) + run);
        const float* vp = kp + AW;
#pragma unroll
        for (int d = 0; d < HD; d += 4) { const f32x4 vv = *(const f32x4*)(vp + d); acc[d] += a * vv[0]; acc[d + 1] += a * vv[1]; acc[d + 2] += a * vv[2]; acc[d + 3] += a * vv[3]; }
        run -= sp;
        if (run < -104.f) break;
    }
    float* op = CAT + (size_t)(b * SEQ + t) * DM + hh * HD;
#pragma unroll
    for (int d = 0; d < HD; ++d) op[d] = acc[d];
}

__global__ __launch_bounds__(256) void gm_prep(const float* __restrict__ H, const float* __restrict__ g, const float* __restrict__ bb, float* __restrict__ VN) {
    const int lane = threadIdx.x & 63, row = blockIdx.x * 4 + (threadIdx.x >> 6);
    const float* vp = H + (size_t)row * INC + 2048;
    float v[8]; float s = 0.f;
#pragma unroll
    for (int j = 0; j < 8; ++j) { v[j] = gelu_exact(vp[lane + 64 * j]); s += v[j]; }
    const float mean = wave_sum(s) * (1.f / 512.f);
    float s2 = 0.f;
#pragma unroll
    for (int j = 0; j < 8; ++j) { v[j] -= mean; s2 += v[j] * v[j]; }
    const float rstd = rsqrtf(wave_sum(s2) * (1.f / 512.f) + LN_EPS);
#pragma unroll
    for (int j = 0; j < 8; ++j) VN[(size_t)row * GW + lane + 64 * j] = v[j] * rstd * g[lane + 64 * j] + bb[lane + 64 * j];
}
__global__ __launch_bounds__(256) void gm_mix(const float* __restrict__ H, const float* __restrict__ VN, const float* __restrict__ ws, const float* __restrict__ bs, float* __restrict__ CAT) {
    const int gid = blockIdx.x * 256 + threadIdx.x;
    const int ch = gid % GW, t = gid / GW, g = ch / 64, tt = t % CH, base = t - tt;
    const float* wr = ws + ((size_t)g * CH + tt) * CH;
    float s = 0.f;
    for (int ss = 0; ss <= tt; ++ss) s += wr[ss] * VN[(size_t)(base + ss) * GW + ch];
    s += bs[g * CH + tt];
    CAT[(size_t)t * DM + AW + ch] = gelu_exact(H[(size_t)t * INC + 1536 + ch]) * s;
}
__global__ __launch_bounds__(256) void cat_rms(float* __restrict__ CAT, const float* __restrict__ ga, const float* __restrict__ gg) {
    const int lane = threadIdx.x & 63, row = blockIdx.x * 4 + (threadIdx.x >> 6);
    float* p = CAT + (size_t)row * DM;
#pragma unroll
    for (int half = 0; half < 2; ++half) {
        float v[8]; float s2 = 0.f;
#pragma unroll
        for (int j = 0; j < 8; ++j) { v[j] = p[half * 512 + lane + 64 * j]; s2 += v[j] * v[j]; }
        const float r = rsqrtf(wave_sum(s2) * (1.f / 512.f) + LN_EPS);
        const float* g = half ? gg : ga;
#pragma unroll
        for (int j = 0; j < 8; ++j) p[half * 512 + lane + 64 * j] = v[j] * r * g[lane + 64 * j];
    }
}
__global__ __launch_bounds__(256) void ln_res(const float* __restrict__ res, const float* __restrict__ add, const float* __restrict__ g, const float* __restrict__ bb, float* __restrict__ out) {
    const int lane = threadIdx.x & 63, row = blockIdx.x * 4 + (threadIdx.x >> 6);
    float v[16]; float s = 0.f;
#pragma unroll
    for (int j = 0; j < 16; ++j) { v[j] = ALPHA * res[(size_t)row * DM + lane + 64 * j] + add[(size_t)row * DM + lane + 64 * j]; s += v[j]; }
    const float mean = wave_sum(s) * (1.f / 1024.f);
    float s2 = 0.f;
#pragma unroll
    for (int j = 0; j < 16; ++j) { v[j] -= mean; s2 += v[j] * v[j]; }
    const float rstd = rsqrtf(wave_sum(s2) * (1.f / 1024.f) + LN_EPS);
#pragma unroll
    for (int j = 0; j < 16; ++j) out[(size_t)row * DM + lane + 64 * j] = v[j] * rstd * g[lane + 64 * j] + bb[lane + 64 * j];
}

__global__ __launch_bounds__(256) void peer_select(const float* __restrict__ QQ, const float* __restrict__ sub, int* __restrict__ IDS, float* __restrict__ GATES) {
    __shared__ float s_s[4][2][16];
    __shared__ int s_i[4][2][16];
    const int lane = threadIdx.x & 63, w = threadIdx.x >> 6;
    const int gw = blockIdx.x * 4 + w, t = gw / PH, h = gw % PH;
#pragma unroll
    for (int p = 0; p < 2; ++p) {
        const float* qp = QQ + (size_t)t * 2048 + h * PQD + p * PHALF;
        const float* k0 = sub + ((size_t)(h * 2 + p) * PNK + lane) * PHALF;
        const float* k1 = k0 + (size_t)64 * PHALF;
        float a = 0.f, b = 0.f;
        for (int k = 0; k < PHALF; k += 4) {
            const f32x4 qv = *(const f32x4*)(qp + k), x0 = *(const f32x4*)(k0 + k), x1 = *(const f32x4*)(k1 + k);
            a += qv[0] * x0[0] + qv[1] * x0[1] + qv[2] * x0[2] + qv[3] * x0[3];
            b += qv[0] * x1[0] + qv[1] * x1[1] + qv[2] * x1[2] + qv[3] * x1[3];
        }
        for (int r = 0; r < PTOPK; ++r) {
            const float m = wave_max(fmaxf(a, b));
            const unsigned long long ba = __ballot(a == m), bbm = __ballot(b == m);
            int idx;
            if (ba) { idx = __ffsll((long long)ba) - 1; if (lane == idx) a = -INFINITY; }
            else { const int l2 = __ffsll((long long)bbm) - 1; idx = l2 + 64; if (lane == l2) b = -INFINITY; }
            if (lane == 0) { s_s[w][p][r] = m; s_i[w][p][r] = idx; }
        }
    }
    __syncthreads();
    float cv[4];
#pragma unroll
    for (int j = 0; j < 4; ++j) { const int c = lane * 4 + j; cv[j] = s_s[w][0][c >> 4] + s_s[w][1][c & 15]; }
    float my_s = 0.f; int my_id = 0;
    for (int r = 0; r < PTOPK; ++r) {
        const float lm = fmaxf(fmaxf(cv[0], cv[1]), fmaxf(cv[2], cv[3]));
        const float m = wave_max(lm);
        const unsigned long long bl = __ballot(lm == m);
        const int l0 = __ffsll((long long)bl) - 1;
        int c = 0;
        if (lane == l0) {
            int j = (cv[0] == m) ? 0 : (cv[1] == m) ? 1 : (cv[2] == m) ? 2 : 3;
            c = lane * 4 + j;
            if (j == 0) cv[0] = -INFINITY; else if (j == 1) cv[1] = -INFINITY; else if (j == 2) cv[2] = -INFINITY; else cv[3] = -INFINITY;
        }
        c = __shfl(c, l0);
        if (lane == r) { my_s = m; my_id = s_i[w][0][c >> 4] * PNK + s_i[w][1][c & 15]; }
    }
    float v = (lane < 16) ? my_s : -INFINITY;
    const float mx = wave_max(v);
    const float e = (lane < 16) ? expf(v - mx) : 0.f;
    const float den = wave_sum(e);
    if (lane < 16) { IDS[(size_t)t * 128 + h * 16 + lane] = my_id; GATES[(size_t)t * 128 + h * 16 + lane] = e / den; }
}
__global__ __launch_bounds__(256) void peer_gather_ln(const float* __restrict__ X1, const int* __restrict__ IDS, const float* __restrict__ GATES, const float* __restrict__ U, const float* __restrict__ V,
                                                       const float* __restrict__ g, const float* __restrict__ bb, float* __restrict__ X2) {
    const int lane = threadIdx.x & 63, t = blockIdx.x * 4 + (threadIdx.x >> 6);
    f32x4 x[4], acc[4];
#pragma unroll
    for (int j = 0; j < 4; ++j) { x[j] = *(const f32x4*)(X1 + (size_t)t * DM + 4 * lane + 256 * j); acc[j] = (f32x4){0.f, 0.f, 0.f, 0.f}; }
    for (int e = 0; e < 128; ++e) {
        const int id = IDS[(size_t)t * 128 + e]; const float gate = GATES[(size_t)t * 128 + e];
        const float* up = U + (size_t)id * DM; const float* vp = V + (size_t)id * DM;
        float d = 0.f;
#pragma unroll
        for (int j = 0; j < 4; ++j) { const f32x4 uv = *(const f32x4*)(up + 4 * lane + 256 * j); d += uv[0] * x[j][0] + uv[1] * x[j][1] + uv[2] * x[j][2] + uv[3] * x[j][3]; }
        d = wave_sum(d);
        const float act = gate * gelu_exact(d);
#pragma unroll
        for (int j = 0; j < 4; ++j) { const f32x4 vv = *(const f32x4*)(vp + 4 * lane + 256 * j); acc[j] += act * vv; }
    }
    float s = 0.f;
#pragma unroll
    for (int j = 0; j < 4; ++j) { acc[j] = ALPHA * x[j] + acc[j]; s += acc[j][0] + acc[j][1] + acc[j][2] + acc[j][3]; }
    const float mean = wave_sum(s) * (1.f / 1024.f);
    float s2 = 0.f;
#pragma unroll
    for (int j = 0; j < 4; ++j) { acc[j] = acc[j] - mean; s2 += acc[j][0] * acc[j][0] + acc[j][1] * acc[j][1] + acc[j][2] * acc[j][2] + acc[j][3] * acc[j][3]; }
    const float rstd = rsqrtf(wave_sum(s2) * (1.f / 1024.f) + LN_EPS);
#pragma unroll
    for (int j = 0; j < 4; ++j) {
        const f32x4 gv = *(const f32x4*)(g + 4 * lane + 256 * j), bv = *(const f32x4*)(bb + 4 * lane + 256 * j);
        *(f32x4*)(X2 + (size_t)t * DM + 4 * lane + 256 * j) = acc[j] * rstd * gv + bv;
    }
}
__global__ __launch_bounds__(256) void ple_ln(const float* __restrict__ X2, const float* __restrict__ G1, const float* __restrict__ G2, const float* __restrict__ bgate,
                                              const float* __restrict__ g, const float* __restrict__ bb, float* __restrict__ out) {
    const int lane = threadIdx.x & 63, row = blockIdx.x * 4 + (threadIdx.x >> 6);
    float v[16]; float s = 0.f;
#pragma unroll
    for (int j = 0; j < 16; ++j) {
        const int c = lane + 64 * j; const size_t o = (size_t)row * DM + c;
        const float gate = 1.f / (1.f + expf(-(G1[o] + bgate[c])));
        v[j] = ALPHA * X2[o] + gate * G2[o]; s += v[j];
    }
    const float mean = wave_sum(s) * (1.f / 1024.f);
    float s2 = 0.f;
#pragma unroll
    for (int j = 0; j < 16; ++j) { v[j] -= mean; s2 += v[j] * v[j]; }
    const float rstd = rsqrtf(wave_sum(s2) * (1.f / 1024.f) + LN_EPS);
#pragma unroll
    for (int j = 0; j < 16; ++j) out[(size_t)row * DM + lane + 64 * j] = v[j] * rstd * g[lane + 64 * j] + bb[lane + 64 * j];
}

extern "C" void kernel_launch(void* const* d_in, const int* in_sizes, int n_in, void* d_out, int out_size, void* d_ws, size_t ws_size, hipStream_t stream) {
    const float* x = (const float*)d_in[0];       const float* p = (const float*)d_in[1];        const float* w_in = (const float*)d_in[2];
    const float* attn_out_g = (const float*)d_in[3]; const float* vn_g = (const float*)d_in[4];   const float* vn_b = (const float*)d_in[5];
    const float* gws = (const float*)d_in[6];     const float* gbs = (const float*)d_in[7];      const float* gm_out_g = (const float*)d_in[8];
    const float* w_out = (const float*)d_in[9];   const float* ln1_g = (const float*)d_in[10];   const float* ln1_b = (const float*)d_in[11];
    const float* wq = (const float*)d_in[12];     const float* sub = (const float*)d_in[13];     const float* pu = (const float*)d_in[14];
    const float* pv = (const float*)d_in[15];     const float* ln2_g = (const float*)d_in[16];   const float* ln2_b = (const float*)d_in[17];
    const float* wproj = (const float*)d_in[18];  const float* wgate = (const float*)d_in[19];   const float* bgate = (const float*)d_in[20];
    const float* ln3_g = (const float*)d_in[21];  const float* ln3_b = (const float*)d_in[22];
    float* out = (float*)d_out;
    char* ws = (char*)d_ws;
    const size_t MiB = 1u << 20;
    float* H = (float*)(ws);
    float* VN = (float*)(ws + 320 * MiB);
    float* CAT = (float*)(ws + 384 * MiB);
    float* MIX = (float*)(ws + 128 * MiB);
    float* X1 = (float*)(ws);
    float* QQ = (float*)(ws + 128 * MiB);
    int* IDS = (int*)(ws + 384 * MiB);
    float* GATES = (float*)(ws + 400 * MiB);
    float* X2 = (float*)(ws + 128 * MiB);
    float* G1 = (float*)(ws + 256 * MiB);
    float* G2 = (float*)(ws + 384 * MiB);

    gemm_f32<<<dim3(INC / 64, T / 64), 256, 0, stream>>>(x, DM, w_in, INC, H, INC, DM);
    attn_naive<<<BATCH * NH * SEQ / 64, 64, 0, stream>>>(H, CAT);
    gm_prep<<<T / 4, 256, 0, stream>>>(H, vn_g, vn_b, VN);
    gm_mix<<<T * GW / 256, 256, 0, stream>>>(H, VN, gws, gbs, CAT);
    cat_rms<<<T / 4, 256, 0, stream>>>(CAT, attn_out_g, gm_out_g);
    gemm_f32<<<dim3(DM / 64, T / 64), 256, 0, stream>>>(CAT, DM, w_out, DM, MIX, DM, DM);
    ln_res<<<T / 4, 256, 0, stream>>>(x, MIX, ln1_g, ln1_b, X1);
    gemm_f32<<<dim3(2048 / 64, T / 64), 256, 0, stream>>>(X1, DM, wq, 2048, QQ, 2048, DM);
    peer_select<<<T * PH / 4, 256, 0, stream>>>(QQ, sub, IDS, GATES);
    peer_gather_ln<<<T / 4, 256, 0, stream>>>(X1, IDS, GATES, pu, pv, ln2_g, ln2_b, X2);
    gemm_f32<<<dim3(DM / 64, T / 64), 256, 0, stream>>>(X2, DM, wgate, DM, G1, DM, DM);
    gemm_f32<<<dim3(DM / 64, T / 64), 256, 0, stream>>>(p, 256, wproj, DM, G2, DM, 256);
    ple_ln<<<T / 4, 256, 0, stream>>>(X2, G1, G2, bgate, ln3_g, ln3_b, out);
}
```

```cpp
#include <hip/hip_runtime.h>
#include <cstdio>
#include <cstdint>

typedef float f32x4 __attribute__((ext_vector_type(4)));
#define LAS __attribute__((address_space(3)))

constexpr int BATCH = 4, SEQ = 8192, T = BATCH * SEQ, DM = 1024, INC = 2560;
constexpr int NH = 8, HD = 64, AW = 512, GW = 512, CH = 128;
constexpr int PH = 8, PNK = 128, PHALF = 128, PQD = 256, PTOPK = 16;
constexpr float LN_EPS = 1e-5f;
constexpr float ALPHA = 1.189207115002721f;
constexpr int NWAVES = 8, NT = NWAVES * 64;
constexpr int LDS_BYTES = 147456;
constexpr int MISC_OFF = 131072 + 320;
constexpr size_t MiB = 1u << 20;
constexpr size_t WS_CTL = 0, CTL_ZERO_BYTES = 64 * 1024;
constexpr size_t WS_DATA = 1 * MiB;

#define XB_TMO      128
#define XB_XCNT(j)  (256  + 64 * (j))
#define XB_XSUB(j)  (1280 + 64 * (j))
#define XB_XGEN(j)  (2304 + 64 * (j))
#define XB_TOP      3328
#define XB_TOPGEN   3392
#define XCD_BAR_WORDS 3456
#define XB_SPIN_CAP (1u << 18)
__device__ __forceinline__ unsigned xb_ld(unsigned* p)              { return __hip_atomic_load(p, __ATOMIC_RELAXED, __HIP_MEMORY_SCOPE_AGENT); }
__device__ __forceinline__ unsigned xb_add(unsigned* p, unsigned v) { return __hip_atomic_fetch_add(p, v, __ATOMIC_RELAXED, __HIP_MEMORY_SCOPE_AGENT); }
__device__ __forceinline__ unsigned xb_xcc_id() { return (unsigned)__builtin_amdgcn_s_getreg((3 << 11) | 20) & 0xFu; }
#define XB_SPIN(cond, bar) do { unsigned _sp = 0; while (cond) { __builtin_amdgcn_s_sleep(1); \
    if ((++_sp & 255u) == 0u) { if (xb_ld(&(bar)[XB_TMO])) break; if (_sp > XB_SPIN_CAP) { atomicAdd(&(bar)[XB_TMO], 1u); break; } } } } while (0)
struct XcdBarrier { unsigned* bar; unsigned x; volatile LAS unsigned* st; };
__device__ __forceinline__ XcdBarrier xcd_barrier_post(unsigned* bar, volatile LAS unsigned* st) {
    XcdBarrier b; b.bar = bar; b.x = xb_xcc_id(); b.st = st;
    if (threadIdx.x == 0) (void)xb_add(&bar[XB_XCNT(b.x)], 1u);
    return b;
}
__device__ __forceinline__ void xcd_barrier_complete(unsigned* bar, unsigned x, unsigned& nloc, unsigned& nx) {
    const unsigned G = gridDim.x * gridDim.y * gridDim.z;
    unsigned sum, cnt, mine, sp = 0u;
    for (;;) {
        sum = 0u; cnt = 0u; mine = 0u;
#pragma unroll
        for (unsigned j = 0; j < 16; ++j) { const unsigned c = xb_ld(&bar[XB_XCNT(j)]); sum += c; cnt += (c > 0u) ? 1u : 0u; mine = (j == x) ? c : mine; }
        if (sum == G) break;
        __builtin_amdgcn_s_sleep(1);
        if ((++sp & 255u) == 0u) { if (xb_ld(&bar[XB_TMO])) break; if (sp > XB_SPIN_CAP) { atomicAdd(&bar[XB_TMO], 1u); break; } }
    }
    nloc = mine > 0u ? mine : 1u; nx = cnt > 0u ? cnt : 1u;
}
__device__ __forceinline__ void xcd_barrier(const XcdBarrier& b) {
    asm volatile("s_waitcnt vmcnt(0)" ::: "memory");
    __syncthreads();
    if (threadIdx.x == 0) {
        unsigned* bar = b.bar;
        __builtin_amdgcn_s_waitcnt(0);
        unsigned nloc = b.st[0], nx = b.st[1];
        if (nloc == 0u) { xcd_barrier_complete(bar, b.x, nloc, nx); b.st[0] = nloc; b.st[1] = nx; }
        const unsigned old = xb_add(&bar[XB_XSUB(b.x)], 1u);
        const unsigned gen = old / nloc;
        if (old + 1u == (gen + 1u) * nloc) {
            __builtin_amdgcn_fence(__ATOMIC_RELEASE, "agent");
            asm volatile("s_waitcnt vmcnt(0)" ::: "memory");
            const unsigned og = xb_add(&bar[XB_TOP], 1u);
            const unsigned tg = og / nx;
            if (og + 1u == (tg + 1u) * nx) xb_add(&bar[XB_TOPGEN], 1u);
            else XB_SPIN(xb_ld(&bar[XB_TOPGEN]) == tg, bar);
            __builtin_amdgcn_fence(__ATOMIC_ACQUIRE, "agent");
            xb_add(&bar[XB_XGEN(b.x)], 1u);
            asm volatile("s_waitcnt vmcnt(0)" ::: "memory");
        } else {
            XB_SPIN(xb_ld(&bar[XB_XGEN(b.x)]) == gen, bar);
            __builtin_amdgcn_fence(__ATOMIC_ACQUIRE, "agent");
            asm volatile("s_waitcnt vmcnt(0)" ::: "memory");
        }
    }
    __syncthreads();
}

__device__ __forceinline__ float wave_sum(float v) {
#pragma unroll
    for (int o = 1; o < 64; o <<= 1) v += __shfl_xor(v, o);
    return v;
}
__device__ __forceinline__ float wave_max(float v) {
#pragma unroll
    for (int o = 1; o < 64; o <<= 1) v = fmaxf(v, __shfl_xor(v, o));
    return v;
}
__device__ __forceinline__ float gelu_exact(float x) { return 0.5f * x * (1.0f + erff(x * 0.70710678118654752f)); }

__device__ __forceinline__ void ph_gemm_f32(float* lds, const float* __restrict__ A, int lda, const float* __restrict__ B, int ldb, float* __restrict__ C, int ldc, int M, int N, int K, int blk, int G) {
    const int tid = threadIdx.x, half = tid >> 8, ht = tid & 255, lane = tid & 63, w = ht >> 6;
    float* sA = lds + half * 2560;
    float* sB = sA + 1280;
    const int ntn = N / 64, ntiles = (M / 64) * ntn, per = 2 * G, iters = (ntiles + per - 1) / per;
    const int ar = ht >> 2, ac = (ht & 3) * 4, br = ht >> 4, bc = (ht & 15) * 4;
    for (int it = 0; it < iters; ++it) {
        const int tile = (it * G + blk) * 2 + half; const bool valid = tile < ntiles;
        const int m0 = valid ? (tile / ntn) * 64 : 0, n0 = valid ? (tile % ntn) * 64 : 0;
        f32x4 acc[4];
#pragma unroll
        for (int i = 0; i < 4; ++i) acc[i] = (f32x4){0.f, 0.f, 0.f, 0.f};
        for (int k0 = 0; k0 < K; k0 += 16) {
            const f32x4 av = *(const f32x4*)(A + (size_t)(m0 + ar) * lda + k0 + ac);
            const f32x4 bv = *(const f32x4*)(B + (size_t)(k0 + br) * ldb + n0 + bc);
            __syncthreads();
            sA[ar * 20 + ac + 0] = av[0]; sA[ar * 20 + ac + 1] = av[1]; sA[ar * 20 + ac + 2] = av[2]; sA[ar * 20 + ac + 3] = av[3];
            sB[br * 68 + bc + 0] = bv[0]; sB[br * 68 + bc + 1] = bv[1]; sB[br * 68 + bc + 2] = bv[2]; sB[br * 68 + bc + 3] = bv[3];
            __syncthreads();
#pragma unroll
            for (int ks = 0; ks < 4; ++ks) {
                const float a = sA[(16 * w + (lane & 15)) * 20 + 4 * ks + (lane >> 4)];
#pragma unroll
                for (int nt = 0; nt < 4; ++nt) {
                    const float b = sB[(4 * ks + (lane >> 4)) * 68 + 16 * nt + (lane & 15)];
                    acc[nt] = __builtin_amdgcn_mfma_f32_16x16x4f32(a, b, acc[nt], 0, 0, 0);
                }
            }
        }
        if (valid) {
#pragma unroll
            for (int nt = 0; nt < 4; ++nt)
#pragma unroll
                for (int j = 0; j < 4; ++j)
                    C[(size_t)(m0 + 16 * w + (lane >> 4) * 4 + j) * ldc + n0 + 16 * nt + (lane & 15)] = acc[nt][j];
        }
    }
    __syncthreads();
}

__device__ __forceinline__ void ph_attn_naive(const float* __restrict__ H, float* __restrict__ CAT, int blk, int G) {
    for (int gid = blk * NT + threadIdx.x; gid < BATCH * NH * SEQ; gid += G * NT) {
        const int t = gid % SEQ, bh = gid / SEQ, hh = bh % NH, b = bh / NH;
        const float* qp = H + (size_t)(b * SEQ + t) * INC + hh * HD;
        float q[HD], acc[HD];
#pragma unroll
        for (int d = 0; d < HD; ++d) { q[d] = qp[d] * 0.125f; acc[d] = 0.f; }
        float run = 0.f;
        for (int s = t - 1; s >= 0; --s) {
            const float* kp = H + (size_t)(b * SEQ + s) * INC + AW + hh * HD;
            float z = 0.f;
#pragma unroll
            for (int d = 0; d < HD; d += 4) { const f32x4 kv = *(const f32x4*)(kp + d); z += q[d] * kv[0] + q[d + 1] * kv[1] + q[d + 2] * kv[2] + q[d + 3] * kv[3]; }
            const float sp = fmaxf(z, 0.f) + log1pf(expf(-fabsf(z)));
            const float a = expf((z - sp) + run);
            const float* vp = kp + AW;
#pragma unroll
            for (int d = 0; d < HD; d += 4) { const f32x4 vv = *(const f32x4*)(vp + d); acc[d] += a * vv[0]; acc[d + 1] += a * vv[1]; acc[d + 2] += a * vv[2]; acc[d + 3] += a * vv[3]; }
            run -= sp;
            if (run < -104.f) break;
        }
        float* op = CAT + (size_t)(b * SEQ + t) * DM + hh * HD;
#pragma unroll
        for (int d = 0; d < HD; ++d) op[d] = acc[d];
    }
}

__device__ __forceinline__ void ph_gm_prep(const float* __restrict__ H, const float* __restrict__ g, const float* __restrict__ bb, float* __restrict__ VN, int gw, int NGW, int lane) {
    for (int row = gw; row < T; row += NGW) {
        const float* vp = H + (size_t)row * INC + 2048;
        float v[8]; float s = 0.f;
#pragma unroll
        for (int j = 0; j < 8; ++j) { v[j] = gelu_exact(vp[lane + 64 * j]); s += v[j]; }
        const float mean = wave_sum(s) * (1.f / 512.f);
        float s2 = 0.f;
#pragma unroll
        for (int j = 0; j < 8; ++j) { v[j] -= mean; s2 += v[j] * v[j]; }
        const float rstd = rsqrtf(wave_sum(s2) * (1.f / 512.f) + LN_EPS);
#pragma unroll
        for (int j = 0; j < 8; ++j) VN[(size_t)row * GW + lane + 64 * j] = v[j] * rstd * g[lane + 64 * j] + bb[lane + 64 * j];
    }
}
__device__ __forceinline__ void ph_gm_mix(const float* __restrict__ H, const float* __restrict__ VN, const float* __restrict__ ws, const float* __restrict__ bs, float* __restrict__ CAT, int blk, int G) {
    for (int gid = blk * NT + threadIdx.x; gid < T * GW; gid += G * NT) {
        const int ch = gid % GW, t = gid / GW, g = ch / 64, tt = t % CH, base = t - tt;
        const float* wr = ws + ((size_t)g * CH + tt) * CH;
        float s = 0.f;
        for (int ss = 0; ss <= tt; ++ss) s += wr[ss] * VN[(size_t)(base + ss) * GW + ch];
        s += bs[g * CH + tt];
        CAT[(size_t)t * DM + AW + ch] = gelu_exact(H[(size_t)t * INC + 1536 + ch]) * s;
    }
}
__device__ __forceinline__ void ph_cat_rms(float* __restrict__ CAT, const float* __restrict__ ga, const float* __restrict__ gg, int gw, int NGW, int lane) {
    for (int row = gw; row < T; row += NGW) {
        float* p = CAT + (size_t)row * DM;
#pragma unroll
        for (int half = 0; half < 2; ++half) {
            float v[8]; float s2 = 0.f;
#pragma unroll
            for (int j = 0; j < 8; ++j) { v[j] = p[half * 512 + lane + 64 * j]; s2 += v[j] * v[j]; }
            const float r = rsqrtf(wave_sum(s2) * (1.f / 512.f) + LN_EPS);
            const float* g = half ? gg : ga;
#pragma unroll
            for (int j = 0; j < 8; ++j) p[half * 512 + lane + 64 * j] = v[j] * r * g[lane + 64 * j];
        }
    }
}
__device__ __forceinline__ void ph_ln_res(const float* __restrict__ res, const float* __restrict__ add, const float* __restrict__ g, const float* __restrict__ bb, float* __restrict__ out, int gw, int NGW, int lane) {
    for (int row = gw; row < T; row += NGW) {
        float v[16]; float s = 0.f;
#pragma unroll
        for (int j = 0; j < 16; ++j) { v[j] = ALPHA * res[(size_t)row * DM + lane + 64 * j] + add[(size_t)row * DM + lane + 64 * j]; s += v[j]; }
        const float mean = wave_sum(s) * (1.f / 1024.f);
        float s2 = 0.f;
#pragma unroll
        for (int j = 0; j < 16; ++j) { v[j] -= mean; s2 += v[j] * v[j]; }
        const float rstd = rsqrtf(wave_sum(s2) * (1.f / 1024.f) + LN_EPS);
#pragma unroll
        for (int j = 0; j < 16; ++j) out[(size_t)row * DM + lane + 64 * j] = v[j] * rstd * g[lane + 64 * j] + bb[lane + 64 * j];
    }
}
__device__ __forceinline__ void ph_peer_select(const float* __restrict__ QQ, const float* __restrict__ sub, int* __restrict__ IDS, float* __restrict__ GATES, int gw0, int NGW, int lane) {
    for (int gw = gw0; gw < T * PH; gw += NGW) {
        const int t = gw / PH, h = gw % PH;
        float sel_s[2]; int sel_i[2];
#pragma unroll
        for (int p = 0; p < 2; ++p) {
            const float* qp = QQ + (size_t)t * 2048 + h * PQD + p * PHALF;
            const float* k0 = sub + ((size_t)(h * 2 + p) * PNK + lane) * PHALF;
            const float* k1 = k0 + (size_t)64 * PHALF;
            float a = 0.f, b = 0.f;
            for (int k = 0; k < PHALF; k += 4) {
                const f32x4 qv = *(const f32x4*)(qp + k), x0 = *(const f32x4*)(k0 + k), x1 = *(const f32x4*)(k1 + k);
                a += qv[0] * x0[0] + qv[1] * x0[1] + qv[2] * x0[2] + qv[3] * x0[3];
                b += qv[0] * x1[0] + qv[1] * x1[1] + qv[2] * x1[2] + qv[3] * x1[3];
            }
            float ms = 0.f; int mi = 0;
            for (int r = 0; r < PTOPK; ++r) {
                const float m = wave_max(fmaxf(a, b));
                const unsigned long long ba = __ballot(a == m), bbm = __ballot(b == m);
                int idx;
                if (ba) { idx = __ffsll((long long)ba) - 1; if (lane == idx) a = -INFINITY; }
                else { const int l2 = __ffsll((long long)bbm) - 1; idx = l2 + 64; if (lane == l2) b = -INFINITY; }
                if (lane == r) { ms = m; mi = idx; }
            }
            sel_s[p] = ms; sel_i[p] = mi;
        }
        float cv[4];
#pragma unroll
        for (int j = 0; j < 4; ++j) { const int c = lane * 4 + j; cv[j] = __shfl(sel_s[0], c >> 4) + __shfl(sel_s[1], c & 15); }
        float my_s = 0.f; int my_id = 0;
        for (int r = 0; r < PTOPK; ++r) {
            const float lm = fmaxf(fmaxf(cv[0], cv[1]), fmaxf(cv[2], cv[3]));
            const float m = wave_max(lm);
            const unsigned long long bl = __ballot(lm == m);
            const int l0 = __ffsll((long long)bl) - 1;
            int c = 0;
            if (lane == l0) {
                const int j = (cv[0] == m) ? 0 : (cv[1] == m) ? 1 : (cv[2] == m) ? 2 : 3;
                c = lane * 4 + j;
                if (j == 0) cv[0] = -INFINITY; else if (j == 1) cv[1] = -INFINITY; else if (j == 2) cv[2] = -INFINITY; else cv[3] = -INFINITY;
            }
            c = __shfl(c, l0);
            const int i1 = __shfl(sel_i[0], c >> 4), i2 = __shfl(sel_i[1], c & 15);
            if (lane == r) { my_s = m; my_id = i1 * PNK + i2; }
        }
        const float v = (lane < 16) ? my_s : -INFINITY;
        const float mx = wave_max(v);
        const float e = (lane < 16) ? expf(v - mx) : 0.f;
        const float den = wave_sum(e);
        if (lane < 16) { IDS[(size_t)t * 128 + h * 16 + lane] = my_id; GATES[(size_t)t * 128 + h * 16 + lane] = e / den; }
    }
}
__device__ __forceinline__ void ph_peer_gather_ln(const float* __restrict__ X1, const int* __restrict__ IDS, const float* __restrict__ GATES, const float* __restrict__ U, const float* __restrict__ V,
                                                   const float* __restrict__ g, const float* __restrict__ bb, float* __restrict__ X2, int gw, int NGW, int lane) {
    for (int t = gw; t < T; t += NGW) {
        f32x4 x[4], acc[4];
#pragma unroll
        for (int j = 0; j < 4; ++j) { x[j] = *(const f32x4*)(X1 + (size_t)t * DM + 4 * lane + 256 * j); acc[j] = (f32x4){0.f, 0.f, 0.f, 0.f}; }
        for (int e = 0; e < 128; ++e) {
            const int id = IDS[(size_t)t * 128 + e]; const float gate = GATES[(size_t)t * 128 + e];
            const float* up = U + (size_t)id * DM; const float* vp = V + (size_t)id * DM;
            float d = 0.f;
#pragma unroll
            for (int j = 0; j < 4; ++j) { const f32x4 uv = *(const f32x4*)(up + 4 * lane + 256 * j); d += uv[0] * x[j][0] + uv[1] * x[j][1] + uv[2] * x[j][2] + uv[3] * x[j][3]; }
            d = wave_sum(d);
            const float act = gate * gelu_exact(d);
#pragma unroll
            for (int j = 0; j < 4; ++j) { const f32x4 vv = *(const f32x4*)(vp + 4 * lane + 256 * j); acc[j] += act * vv; }
        }
        float s = 0.f;
#pragma unroll
        for (int j = 0; j < 4; ++j) { acc[j] = ALPHA * x[j] + acc[j]; s += acc[j][0] + acc[j][1] + acc[j][2] + acc[j][3]; }
        const float mean = wave_sum(s) * (1.f / 1024.f);
        float s2 = 0.f;
#pragma unroll
        for (int j = 0; j < 4; ++j) { acc[j] = acc[j] - mean; s2 += acc[j][0] * acc[j][0] + acc[j][1] * acc[j][1] + acc[j][2] * acc[j][2] + acc[j][3] * acc[j][3]; }
        const float rstd = rsqrtf(wave_sum(s2) * (1.f / 1024.f) + LN_EPS);
#pragma unroll
        for (int j = 0; j < 4; ++j) {
            const f32x4 gv = *(const f32x4*)(g + 4 * lane + 256 * j), bv = *(const f32x4*)(bb + 4 * lane + 256 * j);
            *(f32x4*)(X2 + (size_t)t * DM + 4 * lane + 256 * j) = acc[j] * rstd * gv + bv;
        }
    }
}
__device__ __forceinline__ void ph_ple_ln(const float* __restrict__ X2, const float* __restrict__ G1, const float* __restrict__ G2, const float* __restrict__ bgate,
                                          const float* __restrict__ g, const float* __restrict__ bb, float* __restrict__ out, int gw, int NGW, int lane) {
    for (int row = gw; row < T; row += NGW) {
        float v[16]; float s = 0.f;
#pragma unroll
        for (int j = 0; j < 16; ++j) {
            const int c = lane + 64 * j; const size_t o = (size_t)row * DM + c;
            const float gate = 1.f / (1.f + expf(-(G1[o] + bgate[c])));
            v[j] = ALPHA * X2[o] + gate * G2[o]; s += v[j];
        }
        const float mean = wave_sum(s) * (1.f / 1024.f);
        float s2 = 0.f;
#pragma unroll
        for (int j = 0; j < 16; ++j) { v[j] -= mean; s2 += v[j] * v[j]; }
        const float rstd = rsqrtf(wave_sum(s2) * (1.f / 1024.f) + LN_EPS);
#pragma unroll
        for (int j = 0; j < 16; ++j) out[(size_t)row * DM + lane + 64 * j] = v[j] * rstd * g[lane + 64 * j] + bb[lane + 64 * j];
    }
}

struct Args { const float* in[23]; float* out; unsigned char* ws; };
__global__ void __launch_bounds__(NT, 2) mega_fwd(Args a) {
    extern __shared__ __attribute__((aligned(16))) unsigned char lds[];
    const int tid = threadIdx.x, lane = tid & 63, wave = __builtin_amdgcn_readfirstlane(tid >> 6);
    const int G = gridDim.x, blk = blockIdx.x, gw = blk * NWAVES + wave, NGW = G * NWAVES;
    volatile LAS unsigned* MISC = (volatile LAS unsigned*)((LAS unsigned char*)lds + MISC_OFF);
    if (tid < 32) MISC[tid] = 0u;
    __syncthreads();
    unsigned* ctl = (unsigned*)(a.ws + WS_CTL);
    XcdBarrier bar = xcd_barrier_post(ctl + 4096, MISC + 8);
    const float* x = a.in[0];       const float* p = a.in[1];        const float* w_in = a.in[2];
    const float* attn_out_g = a.in[3]; const float* vn_g = a.in[4];   const float* vn_b = a.in[5];
    const float* gws = a.in[6];     const float* gbs = a.in[7];      const float* gm_out_g = a.in[8];
    const float* w_out = a.in[9];   const float* ln1_g = a.in[10];   const float* ln1_b = a.in[11];
    const float* wq = a.in[12];     const float* sub = a.in[13];     const float* pu = a.in[14];
    const float* pv = a.in[15];     const float* ln2_g = a.in[16];   const float* ln2_b = a.in[17];
    const float* wproj = a.in[18];  const float* wgate = a.in[19];   const float* bgate = a.in[20];
    const float* ln3_g = a.in[21];  const float* ln3_b = a.in[22];
    float* out = a.out;
    unsigned char* ws = a.ws + WS_DATA;
    float* H = (float*)(ws);
    float* VN = out;
    float* CAT = (float*)(ws + 320 * MiB);
    float* MIX = (float*)(ws + 128 * MiB);
    float* X1 = (float*)(ws);
    float* QQ = (float*)(ws + 128 * MiB);
    int* IDS = (int*)(ws + 384 * MiB);
    float* GATES = (float*)(ws + 400 * MiB);
    float* X2 = (float*)(ws + 128 * MiB);
    float* G1 = (float*)(ws + 256 * MiB);
    float* G2 = (float*)(ws);
    float* ldsf = (float*)lds;

    ph_gemm_f32(ldsf, x, DM, w_in, INC, H, INC, T, INC, DM, blk, G);
    xcd_barrier(bar);
    ph_attn_naive(H, CAT, blk, G);
    ph_gm_prep(H, vn_g, vn_b, VN, gw, NGW, lane);
    xcd_barrier(bar);
    ph_gm_mix(H, VN, gws, gbs, CAT, blk, G);
    xcd_barrier(bar);
    ph_cat_rms(CAT, attn_out_g, gm_out_g, gw, NGW, lane);
    xcd_barrier(bar);
    ph_gemm_f32(ldsf, CAT, DM, w_out, DM, MIX, DM, T, DM, DM, blk, G);
    xcd_barrier(bar);
    ph_ln_res(x, MIX, ln1_g, ln1_b, X1, gw, NGW, lane);
    xcd_barrier(bar);
    ph_gemm_f32(ldsf, X1, DM, wq, 2048, QQ, 2048, T, 2048, DM, blk, G);
    xcd_barrier(bar);
    ph_peer_select(QQ, sub, IDS, GATES, gw, NGW, lane);
    xcd_barrier(bar);
    ph_peer_gather_ln(X1, IDS, GATES, pu, pv, ln2_g, ln2_b, X2, gw, NGW, lane);
    xcd_barrier(bar);
    ph_gemm_f32(ldsf, X2, DM, wgate, DM, G1, DM, T, DM, DM, blk, G);
    ph_gemm_f32(ldsf, p, 256, wproj, DM, G2, DM, T, DM, 256, blk, G);
    xcd_barrier(bar);
    ph_ple_ln(X2, G1, G2, bgate, ln3_g, ln3_b, out, gw, NGW, lane);
}

extern "C" void kernel_launch(void* const* d_in, const int* in_sizes, int n_in, void* d_out, int out_size, void* d_ws, size_t ws_size, hipStream_t stream) {
    static int grid = 0;
    if (grid == 0) {
        int dev = 0, cus = 0;
        if (hipGetDevice(&dev) != hipSuccess || hipDeviceGetAttribute(&cus, hipDeviceAttributeMultiprocessorCount, dev) != hipSuccess) { fprintf(stderr, "kernel_launch: device query failed\n"); grid = -1; return; }
        if (hipFuncSetAttribute((const void*)mega_fwd, hipFuncAttributeMaxDynamicSharedMemorySize, LDS_BYTES) != hipSuccess) { fprintf(stderr, "kernel_launch: hipFuncSetAttribute failed\n"); grid = -1; return; }
        int per_cu = 0;
        if (hipOccupancyMaxActiveBlocksPerMultiprocessor(&per_cu, (const void*)mega_fwd, NT, LDS_BYTES) != hipSuccess || per_cu < 1) fprintf(stderr, "kernel_launch: occupancy query reports %d\n", per_cu);
        (void)hipGetLastError();
        grid = cus;
        if (n_in != 23 || ws_size < 450 * MiB) fprintf(stderr, "kernel_launch: unexpected n_in %d / ws_size %zu\n", n_in, ws_size);
    }
    if (grid < 0) return;
    (void)hipMemsetAsync((char*)d_ws + WS_CTL, 0, CTL_ZERO_BYTES, stream);
    Args a{};
    for (int i = 0; i < 23; ++i) a.in[i] = (const float*)d_in[i];
    a.out = (float*)d_out; a.ws = (unsigned char*)d_ws;
    hipLaunchKernelGGL(mega_fwd, dim3(grid), dim3(NT), LDS_BYTES, stream, a);
}
```
